# Optimizing an MI355X kernel written in HIP

```python
import math
import jax, jax.numpy as jnp
from jax import lax
import numpy as np

D_MODEL = 1024
BATCH = 4
SEQ = 4096
DEPTH = 4

RET_HEADS = 8
RET_DK = 64
RET_DV = 128
RET_CHUNK = 128
CONV_W = 1024
CONV_K = 3
MLA_HEADS = 8
MLA_NOPE = 128
MLA_ROPE = 64
MLA_DV = 128
Q_LORA = 384
KV_LORA = 256
ATTN_BLOCK = 128
ROPE_BASE = 10000.0
EPS = 1e-6
N_EVEN = (DEPTH + 1) // 2
N_ODD = DEPTH // 2

RET_QK = RET_HEADS * RET_DK
RET_V = RET_HEADS * RET_DV
EVEN_SPLITS = (RET_QK, RET_QK, RET_V, RET_V, CONV_W, CONV_W, CONV_W, CONV_W)
EVEN_IN = sum(EVEN_SPLITS)
EVEN_MIX = RET_V + CONV_W
MLA_QK = MLA_NOPE + MLA_ROPE
MLA_V = MLA_HEADS * MLA_DV
ODD_SPLITS = (Q_LORA, KV_LORA, MLA_ROPE, MLA_V)
ODD_IN = sum(ODD_SPLITS)

kernel_name = "hybrid_retnet_shortconv_mla_trunk"


def rms_norm(x, g):
    xf = x.astype(jnp.float32)
    y = xf * lax.rsqrt(jnp.mean(xf * xf, axis=-1, keepdims=True) + EPS)
    return (y * g.astype(jnp.float32)).astype(x.dtype)


def rope(x, positions):
    d = x.shape[-1]
    inv = ROPE_BASE ** (-jnp.arange(0, d, 2, dtype=jnp.float32) / d)
    ang = positions.astype(jnp.float32)[..., None] * inv
    cos = jnp.cos(ang)[:, :, None, :]
    sin = jnp.sin(ang)[:, :, None, :]
    xf = x.astype(jnp.float32)
    x1, x2 = xf[..., : d // 2], xf[..., d // 2:]
    out = jnp.concatenate([x1 * cos - x2 * sin, x1 * sin + x2 * cos], axis=-1)
    return out.astype(x.dtype)


def split_cols(h, sizes):
    return jnp.split(h, np.cumsum(sizes)[:-1].tolist(), axis=-1)


def retention(q, k, v):
    b, s, h, dk = q.shape
    dv = v.shape[-1]
    c = RET_CHUNK
    n = s // c
    dt = q.dtype
    log_gamma = jnp.log1p(-jnp.exp2(-5.0 - jnp.arange(h, dtype=jnp.float32)))
    i = jnp.arange(c, dtype=jnp.float32)
    rel = i[:, None] - i[None, :]
    intra = jnp.where(rel >= 0, jnp.exp(log_gamma[:, None, None] * jnp.maximum(rel, 0.0)), 0.0).astype(dt)
    xi = jnp.exp(log_gamma[:, None] * (i + 1.0)).astype(dt)
    zeta = jnp.exp(log_gamma[:, None] * (c - 1.0 - i)).astype(dt)
    gamma_c = jnp.exp(log_gamma * c).astype(dt)
    qc = q.reshape(b, n, c, h, dk)
    kc = k.reshape(b, n, c, h, dk)
    vc = v.reshape(b, n, c, h, dv)
    scores = jnp.einsum('bnihd,bnjhd->bnhij', qc, kc) * intra
    inner = jnp.einsum('bnhij,bnjhe->bnihe', scores, vc)
    kv = jnp.einsum('bnjhd,hj,bnjhe->nbhde', kc, zeta, vc)

    def step(state, kv_i):
        return gamma_c[None, :, None, None] * state + kv_i, state

    _, prev = lax.scan(step, jnp.zeros((b, h, dk, dv), dt), kv)
    cross = jnp.einsum('bnihd,nbhde,hi->bnihe', qc, prev, xi)
    return (inner + cross).reshape(b, s, h, dv)


def short_conv(u, w, bias):
    s = u.shape[1]
    up = jnp.pad(u, ((0, 0), (CONV_K - 1, 0), (0, 0)))
    out = up[:, 0:s] * w[0]
    for tap in range(1, CONV_K):
        out = out + up[:, tap:tap + s] * w[tap]
    return out + bias


def even_layer(h, positions, w_in, conv_w, conv_b, gn, w_out):
    b, s, _ = h.shape
    q, k, v, g_ret, cb, cc, cx, g_conv = split_cols(h @ w_in, EVEN_SPLITS)
    q = rope(q.reshape(b, s, RET_HEADS, RET_DK), positions)
    k = rope(k.reshape(b, s, RET_HEADS, RET_DK), positions) * (RET_DK ** -0.5)
    v = v.reshape(b, s, RET_HEADS, RET_DV)
    r = retention(q, k, v)
    r = rms_norm(r, gn.reshape(RET_HEADS, RET_DV)).reshape(b, s, RET_V)
    y_conv = cb * short_conv(cc * cx, conv_w, conv_b)
    mix = jnp.concatenate([r * jax.nn.silu(g_ret), y_conv * jax.nn.silu(g_conv)], axis=-1)
    return mix @ w_out


def causal_mla_attention(q_nope, q_rope, k_nope, k_rope, v):
    s = q_nope.shape[1]
    scale = MLA_QK ** -0.5
    outs = []
    for blk in range(s // ATTN_BLOCK):
        lo, hi = blk * ATTN_BLOCK, (blk + 1) * ATTN_BLOCK
        sc = (jnp.einsum('bqhd,bkhd->bhqk', q_nope[:, lo:hi].astype(jnp.float32), k_nope[:, :hi].astype(jnp.float32))
              + jnp.einsum('bqhd,bkd->bhqk', q_rope[:, lo:hi].astype(jnp.float32), k_rope[:, :hi].astype(jnp.float32))) * scale
        qpos = lo + jnp.arange(ATTN_BLOCK)
        kpos = jnp.arange(hi)
        sc = jnp.where(kpos[None, :] <= qpos[:, None], sc, -jnp.inf)
        p = jax.nn.softmax(sc, axis=-1).astype(v.dtype)
        outs.append(jnp.einsum('bhqk,bkhd->bqhd', p, v[:, :hi]))
    return jnp.concatenate(outs, axis=1)


def odd_layer(h, positions, w_in, q_a_norm, w_qb, kv_a_norm, w_kvb, w_out):
    b, s, _ = h.shape
    cq, ckv, k_rope, gate = split_cols(h @ w_in, ODD_SPLITS)
    q = (rms_norm(cq, q_a_norm) @ w_qb).reshape(b, s, MLA_HEADS, MLA_QK)
    q_nope = q[..., :MLA_NOPE]
    q_rope = rope(q[..., MLA_NOPE:], positions)
    kv = (rms_norm(ckv, kv_a_norm) @ w_kvb).reshape(b, s, MLA_HEADS, MLA_NOPE + MLA_DV)
    k_nope, v = kv[..., :MLA_NOPE], kv[..., MLA_NOPE:]
    k_rope = rope(k_rope[:, :, None, :], positions)[:, :, 0]
    o = causal_mla_attention(q_nope, q_rope, k_nope, k_rope, v)
    return (o.reshape(b, s, MLA_V) * jax.nn.silu(gate)) @ w_out


def setup_inputs(seed: int = 0) -> dict:
    key = jax.random.key(seed)
    ks = jax.random.split(key, 16)
    f32 = jnp.float32
    nrm = lambda k, shape, scale: jax.random.normal(k, shape, f32) * scale
    x = jax.random.normal(ks[0], (BATCH, SEQ, D_MODEL), f32)
    offsets = jax.random.randint(ks[1], (BATCH, 1), 0, 1024, dtype=jnp.int32)
    positions = (offsets + jnp.arange(SEQ, dtype=jnp.int32)[None, :]).astype(jnp.int32)
    pre_norm = 1.0 + nrm(ks[2], (DEPTH, D_MODEL), 0.02)
    post_norm = 1.0 + nrm(ks[3], (DEPTH, D_MODEL), 0.02)
    even_w_in = nrm(ks[4], (N_EVEN, D_MODEL, EVEN_IN), D_MODEL ** -0.5)
    even_conv_w = nrm(ks[5], (N_EVEN, CONV_K, CONV_W), CONV_K ** -0.5)
    even_conv_b = nrm(ks[6], (N_EVEN, CONV_W), 0.01)
    ret_gn = 1.0 + nrm(ks[7], (N_EVEN, RET_V), 0.02)
    even_w_out = nrm(ks[8], (N_EVEN, EVEN_MIX, D_MODEL), EVEN_MIX ** -0.5)
    odd_w_in = nrm(ks[9], (N_ODD, D_MODEL, ODD_IN), D_MODEL ** -0.5)
    q_a_norm = 1.0 + nrm(ks[10], (N_ODD, Q_LORA), 0.02)
    w_qb = nrm(ks[11], (N_ODD, Q_LORA, MLA_HEADS * MLA_QK), Q_LORA ** -0.5)
    kv_a_norm = 1.0 + nrm(ks[12], (N_ODD, KV_LORA), 0.02)
    w_kvb = nrm(ks[13], (N_ODD, KV_LORA, MLA_HEADS * (MLA_NOPE + MLA_DV)), KV_LORA ** -0.5)
    odd_w_out = nrm(ks[14], (N_ODD, MLA_V, D_MODEL), MLA_V ** -0.5)
    return {"x": x, "positions": positions, "pre_norm": pre_norm, "post_norm": post_norm,
            "even_w_in": even_w_in, "even_conv_w": even_conv_w, "even_conv_b": even_conv_b,
            "ret_gn": ret_gn, "even_w_out": even_w_out, "odd_w_in": odd_w_in,
            "q_a_norm": q_a_norm, "w_qb": w_qb, "kv_a_norm": kv_a_norm, "w_kvb": w_kvb,
            "odd_w_out": odd_w_out}


def reference(x, positions, pre_norm, post_norm, even_w_in, even_conv_w, even_conv_b, ret_gn,
              even_w_out, odd_w_in, q_a_norm, w_qb, kv_a_norm, w_kvb, odd_w_out):
    h = x
    for layer in range(DEPTH):
        u = rms_norm(h, pre_norm[layer])
        if layer % 2 == 0:
            e = layer // 2
            y = even_layer(u, positions, even_w_in[e], even_conv_w[e], even_conv_b[e], ret_gn[e], even_w_out[e])
        else:
            o = layer // 2
            y = odd_layer(u, positions, odd_w_in[o], q_a_norm[o], w_qb[o], kv_a_norm[o], w_kvb[o], odd_w_out[o])
        h = h + rms_norm(y, post_norm[layer])
    return h
```

```cpp
#include <hip/hip_runtime.h>
#include <cstdio>
#include <cstdint>

#define LAS __attribute__((address_space(3)))
#define GAS __attribute__((address_space(1)))
typedef unsigned short bf16_t;
typedef short bf16x8 __attribute__((ext_vector_type(8)));
typedef short s16x4 __attribute__((ext_vector_type(4)));
typedef short v4i16 __attribute__((ext_vector_type(4)));
typedef float f32x2 __attribute__((ext_vector_type(2)));
typedef float f32x4 __attribute__((ext_vector_type(4)));
typedef float f32x16 __attribute__((ext_vector_type(16)));
typedef unsigned u32x2 __attribute__((ext_vector_type(2)));
typedef unsigned u32x4 __attribute__((ext_vector_type(4)));
typedef __bf16 bf16x2_t __attribute__((ext_vector_type(2)));

constexpr int T = 16384, DM = 1024, SEQ = 4096, NBATCH = 4;
constexpr int PW = 5120;
constexpr int PQ = 0, PK = 512, PV = 1024, PSG = 2048, PGATE = 3072, PU = 4096;
constexpr int E_NIN = 7168, O_NIN = 1792, O_NQ = 1536, O_NKV = 2048;
constexpr float EPS = 1e-6f;
constexpr float LOG2E = 1.4426950408889634f;
constexpr float QSCALE = 0.07216878364870322f * 1.4426950408889634f;

constexpr size_t MiB = 1u << 20;
constexpr size_t WS_CTL = 0, CTL_ZERO_BYTES = 1 * MiB;
constexpr size_t WS_COS = 1 * MiB, WS_SIN = 3 * MiB;
constexpr size_t WS_W = 5 * MiB;
constexpr size_t W_EIN = 0, W_EOUT = 14 * MiB, W_OIN = 18 * MiB, W_OQB = W_OIN + 3584 * 1024, W_OKVB = W_OQB + 1152 * 1024, W_OOUT = W_OKVB + 1 * MiB, W_LAYER = W_OOUT + 2 * MiB;
static_assert(W_LAYER == 26240 * 1024, "weight map");
constexpr size_t WS_UN = 58 * MiB;
constexpr size_t WS_BIG = 90 * MiB;
constexpr size_t B_SG = 0, B_Q = 32 * MiB, B_V = 80 * MiB, B_CQ = 112 * MiB, B_CKV = 124 * MiB, B_KR = 132 * MiB, B_SS = 134 * MiB;
constexpr size_t WS_END = 250 * MiB;
static_assert(WS_W + 2 * W_LAYER <= WS_UN && WS_UN + 32 * MiB <= WS_BIG && WS_BIG + 160 * MiB <= WS_END, "ws map");
constexpr int SSW = 32;

constexpr int CW_BAR = 4096;

constexpr int RING_BYTES = 131072;
constexpr int MISC_OFF = RING_BYTES + 320;
constexpr int LDS_BYTES = 147456;

__device__ __forceinline__ unsigned cvtpk(float lo, float hi) { f32x2 v = {lo, hi}; bf16x2_t b = __builtin_convertvector(v, bf16x2_t); return __builtin_bit_cast(unsigned, b); }
__device__ __forceinline__ float bflo(unsigned u) { return __uint_as_float(u << 16); }
__device__ __forceinline__ float bfhi(unsigned u) { return __uint_as_float(u & 0xffff0000u); }
__device__ __forceinline__ float silu_f(float x) { return x * __builtin_amdgcn_rcpf(1.f + __builtin_amdgcn_exp2f(-x * LOG2E)); }
__device__ __forceinline__ float wave_sum(float v) {
#pragma unroll
    for (int o = 1; o < 64; o <<= 1) v += __shfl_xor(v, o);
    return v;
}
__device__ __forceinline__ int crow(int r, int hi) { return (r & 3) + 8 * (r >> 2) + 4 * hi; }
__device__ __forceinline__ int rope_d(int o) { return ((o >> 5) & 1) * 16 + ((o >> 3) & 3) * 4 + (o & 3) + ((o >> 2) & 1) * 32; }
__device__ __forceinline__ int otid() { int t = threadIdx.x; asm volatile("" : "+v"(t)); return t; }
#define LDS_WAIT() asm volatile("s_waitcnt lgkmcnt(0)" ::: "memory")
#define VM_WAIT() asm volatile("s_waitcnt vmcnt(0)" ::: "memory")

namespace pg8 {
#define PG8_LAS __attribute__((address_space(3)))
constexpr int BM = 256, BK = 64, HALF = 128, HTB = HALF * BK * 2, STAGE_BYTES = 8 * HTB, NXCD = 8, WGM = 8;
__host__ __device__ __forceinline__ int lds_byte(int r, int c) { const int st = (r >> 4) * 2 + (c >> 5), rr = r & 15, cc = c & 31, ob = rr * 64 + cc * 2; return st * 1024 + (ob ^ (((ob >> 9) & 1) << 5)); }
__host__ __device__ __forceinline__ void stage_rc(int b, int& R, int& C) { const int st = b / 1024, sb = b % 1024, swz = sb ^ (((sb >> 9) & 1) << 5); R = (st >> 1) * 16 + swz / 64; C = (st & 1) * 32 + (swz % 64) / 2; }
__host__ __device__ __forceinline__ int perm32(int rho) { const int n = rho >> 4, i = rho & 15; return 8 * (i >> 2) + 4 * n + (i & 3); }

struct Unit { int pm, pn; };
struct Gemm { const bf16_t* A; const bf16_t* Bt; int M, N, K, lda; };

struct StaticOrder {
    int nM, nN, nwg, G, c;
    __host__ __device__ void init(int M, int N, int G_, int c_) { nM = M / BM; nN = N / BM; nwg = nM * nN; G = G_; c = c_; }
    __host__ __device__ bool next(int i, Unit& u) const {
        const long L = (long)i * G + c; if (L >= nwg) return false;
        int wgid = (int)L; { const int q = nwg / NXCD, r = nwg % NXCD, xcd = wgid % NXCD, off = wgid / NXCD; wgid = (xcd < r ? xcd * (q + 1) : r * (q + 1) + (xcd - r) * q) + off; }
        const int nig = WGM * nN, gid = wgid / nig, fm = gid * WGM, gsz = (nM - fm) < WGM ? (nM - fm) : WGM;
        u.pm = fm + ((wgid % nig) % gsz); u.pn = (wgid % nig) / gsz; return true;
    }
};

template <class Epi, class Sched, bool ALIGN_EPI>
__device__ __forceinline__ void gemm_phase(PG8_LAS unsigned char* lds, const Gemm g, const Sched& S, const Epi& E) {
    const int tid = otid(), wid = __builtin_amdgcn_readfirstlane(tid >> 6), lane = tid & 63, wr = wid >> 2, wc = wid & 3, fr = lane & 15, fq = lane >> 4;
    const int K = g.K, nt = K / BK, lda = g.lda;
    unsigned voffA[2], voffB[2];
#pragma unroll
    for (int i = 0; i < 2; ++i) { int R, C; stage_rc(tid * 16 + i * 8192, R, C); const int Rb = Epi::PERM ? ((R & ~31) + perm32(R & 31)) : R;
        voffA[i] = (unsigned)(R * lda + C) * 2u; voffB[i] = (unsigned)(Rb * K + C) * 2u; }
    const size_t kstep = (size_t)(BK * 2);
    const size_t hstepA = (size_t)HALF * lda * 2, hstepB = (size_t)HALF * K * 2;
    const size_t tstepA = 2 * hstepA, tstepB = 2 * hstepB;
    const unsigned ldsw = (unsigned)wid * 1024u;
    const int aoff = lds_byte(wr * 64 + fr, fq * 8), boff = lds_byte(wc * 32 + fr, fq * 8);
#define PG8_SA(b, h) (((b) * 2 + (h)) * HTB)
#define PG8_SB(b, h) ((4 + (b) * 2 + (h)) * HTB)
#define PG8_STAGE(bufoff, gbase, voff) do { _Pragma("unroll") for (int _i = 0; _i < 2; ++_i) \
        __builtin_amdgcn_global_load_lds((const unsigned*)((const char*)(gbase) + (voff)[_i]), (PG8_LAS unsigned*)(lds + (bufoff) + ldsw + _i * 8192), 16, 0, 0); } while (0)
#define PG8_LDA(dst, b, h) do { _Pragma("unroll") for (int m = 0; m < 4; ++m) _Pragma("unroll") for (int k = 0; k < 2; ++k) dst[m][k] = *(const PG8_LAS bf16x8*)(lds + PG8_SA(b, h) + aoff + m * 2048 + k * 1024); } while (0)
#define PG8_LDB(dst, b, h) do { _Pragma("unroll") for (int n = 0; n < 2; ++n) _Pragma("unroll") for (int k = 0; k < 2; ++k) dst[n][k] = *(const PG8_LAS bf16x8*)(lds + PG8_SB(b, h) + boff + n * 2048 + k * 1024); } while (0)
#define PG8_MMA(ai, bj, At, Bt) do { __builtin_amdgcn_s_setprio(1); _Pragma("unroll") for (int m = 0; m < 4; ++m) _Pragma("unroll") for (int n = 0; n < 2; ++n) _Pragma("unroll") for (int k = 0; k < 2; ++k) \
        acc[ai][bj][m][n] = __builtin_amdgcn_mfma_f32_16x16x32_bf16(Bt[n][k], At[m][k], acc[ai][bj][m][n], 0, 0, 0); __builtin_amdgcn_s_setprio(0); } while (0)
#define PG8_WAIT_V(n) asm volatile("s_waitcnt vmcnt(" #n ")" ::: "memory")
#define PG8_WAIT_L(n) asm volatile("s_waitcnt lgkmcnt(" #n ")" ::: "memory")
#define PG8_BAR __builtin_amdgcn_s_barrier()
#define PG8_SCHED __builtin_amdgcn_sched_barrier(0)
    Unit cur, nxt; int ui = 0;
    if (!S.next(0, cur)) return;
    f32x4 acc[2][2][4][2];
#pragma unroll
    for (int a = 0; a < 2; ++a)
#pragma unroll
        for (int b = 0; b < 2; ++b)
#pragma unroll
            for (int m = 0; m < 4; ++m)
#pragma unroll
                for (int n = 0; n < 2; ++n) acc[a][b][m][n] = (f32x4){0.f, 0.f, 0.f, 0.f};
    bf16x8 At[4][2], B0[2][2], B1[2][2];
    const char* cA = (const char*)g.A + (size_t)cur.pm * tstepA; const char* cB = (const char*)g.Bt + (size_t)cur.pn * tstepB;
    PG8_STAGE(PG8_SB(0, 0), cB, voffB); PG8_STAGE(PG8_SB(0, 1), cB + hstepB, voffB); PG8_STAGE(PG8_SA(0, 0), cA, voffA); PG8_STAGE(PG8_SA(0, 1), cA + hstepA, voffA);
    if (wr == 1) PG8_BAR;
    PG8_WAIT_V(2); PG8_BAR;
    PG8_STAGE(PG8_SB(1, 0), cB + kstep, voffB); PG8_STAGE(PG8_SA(1, 0), cA + kstep, voffA); PG8_STAGE(PG8_SB(1, 1), cB + hstepB + kstep, voffB);
    PG8_WAIT_V(6); PG8_BAR;
    for (;;) {
        const bool has_next = S.next(ui + 1, nxt);
        const char* nA = has_next ? (const char*)g.A + (size_t)nxt.pm * tstepA : cA; const char* nB = has_next ? (const char*)g.Bt + (size_t)nxt.pn * tstepB : cB;
#pragma unroll 1
        for (int t = 0; t < nt; t += 2) {
            const bool last = (t == nt - 2);
            const char* a1 = cA + (size_t)(t + 1) * kstep;
            const char* a2 = last ? nA : cA + (size_t)(t + 2) * kstep; const char* b2 = last ? nB : cB + (size_t)(t + 2) * kstep;
            const char* a3 = a2 + kstep; const char* b3 = b2 + kstep;
            PG8_LDB(B0, 0, 0); PG8_LDB(B1, 0, 1); PG8_SCHED; PG8_LDA(At, 0, 0); PG8_STAGE(PG8_SA(1, 1), a1 + hstepA, voffA);
            PG8_WAIT_V(8); PG8_WAIT_L(0); PG8_BAR; PG8_MMA(0, 0, At, B0); PG8_MMA(0, 1, At, B1); PG8_BAR; PG8_SCHED;
            PG8_LDA(At, 0, 1); PG8_STAGE(PG8_SB(0, 0), b2, voffB); PG8_STAGE(PG8_SB(0, 1), b2 + hstepB, voffB); PG8_STAGE(PG8_SA(0, 0), a2, voffA);
            PG8_WAIT_V(8); PG8_WAIT_L(0); PG8_BAR; PG8_MMA(1, 0, At, B0); PG8_MMA(1, 1, At, B1); PG8_BAR; PG8_SCHED;
            PG8_LDB(B0, 1, 0); PG8_LDB(B1, 1, 1); PG8_SCHED; PG8_LDA(At, 1, 0); PG8_STAGE(PG8_SA(0, 1), a2 + hstepA, voffA);
            PG8_WAIT_V(8); PG8_WAIT_L(0); PG8_BAR; PG8_MMA(0, 0, At, B0); PG8_MMA(0, 1, At, B1); PG8_BAR; PG8_SCHED;
            PG8_LDA(At, 1, 1); PG8_STAGE(PG8_SB(1, 0), b3, voffB); PG8_STAGE(PG8_SB(1, 1), b3 + hstepB, voffB); PG8_STAGE(PG8_SA(1, 0), a3, voffA);
            PG8_WAIT_V(8); PG8_WAIT_L(0); PG8_BAR; PG8_MMA(1, 0, At, B0); PG8_MMA(1, 1, At, B1); PG8_BAR; PG8_SCHED;
        }
        if constexpr (ALIGN_EPI) { if (wr == 0) PG8_BAR; }
        E(acc, cur, wr, wc, fr, fq);
        if (!has_next) break;
#pragma unroll
        for (int a = 0; a < 2; ++a)
#pragma unroll
            for (int b = 0; b < 2; ++b)
#pragma unroll
                for (int m = 0; m < 4; ++m)
#pragma unroll
                    for (int n = 0; n < 2; ++n) acc[a][b][m][n] = (f32x4){0.f, 0.f, 0.f, 0.f};
        cur = nxt; cA = nA; cB = nB; ++ui;
        if constexpr (ALIGN_EPI) { if (wr == 1) PG8_BAR; }
    }
    PG8_WAIT_V(0);
    if constexpr (!ALIGN_EPI) { if (wr == 0) PG8_BAR; }
    PG8_BAR;
#undef PG8_SA
#undef PG8_SB
#undef PG8_STAGE
#undef PG8_LDA
#undef PG8_LDB
#undef PG8_MMA
#undef PG8_WAIT_V
#undef PG8_WAIT_L
#undef PG8_BAR
#undef PG8_SCHED
}

__device__ __forceinline__ u32x4 pack8(const f32x4 a, const f32x4 b) { u32x4 w; w.x = cvtpk(a[0], a[1]); w.y = cvtpk(a[2], a[3]); w.z = cvtpk(b[0], b[1]); w.w = cvtpk(b[2], b[3]); return w; }

struct EpiEvenIn {
    static constexpr bool PERM = true;
    bf16_t* P; const float* cosT; const float* sinT;
    __device__ __forceinline__ void operator()(const f32x4 (&acc)[2][2][4][2], const Unit& u, int wr, int wc, int fr, int fq) const {
        const int pn = u.pn, row0 = u.pm * BM + wr * 64 + fr;
        if (pn < 4) {
            const float sc = pn >= 2 ? 0.125f : 1.0f;
            const int dbase = (wc & 1) * 16 + 4 * fq;
#pragma unroll
            for (int ai = 0; ai < 2; ++ai)
#pragma unroll
                for (int m = 0; m < 4; ++m) { const int row = row0 + ai * HALF + m * 16;
                    const f32x4 cs = *(const f32x4*)(cosT + (size_t)row * 32 + dbase) * sc, sn = *(const f32x4*)(sinT + (size_t)row * 32 + dbase) * sc;
#pragma unroll
                    for (int bj = 0; bj < 2; ++bj) { const f32x4 a = acc[ai][bj][m][0], b = acc[ai][bj][m][1];
                        const f32x4 o0 = a * cs - b * sn, o1 = a * sn + b * cs;
                        *(u32x4*)(P + (size_t)row * PW + pn * BM + bj * HALF + wc * 32 + 8 * fq) = pack8(o0, o1); } }
        } else if (pn < 12) {
            const bool sl = pn >= 8;
#pragma unroll
            for (int ai = 0; ai < 2; ++ai)
#pragma unroll
                for (int m = 0; m < 4; ++m) { const int row = row0 + ai * HALF + m * 16;
#pragma unroll
                    for (int bj = 0; bj < 2; ++bj) { f32x4 a = acc[ai][bj][m][0], b = acc[ai][bj][m][1];
                        if (sl) {
#pragma unroll
                            for (int j = 0; j < 4; ++j) { a[j] = silu_f(a[j]); b[j] = silu_f(b[j]); } }
                        *(u32x4*)(P + (size_t)row * PW + pn * BM + bj * HALF + wc * 32 + 8 * fq) = pack8(a, b); } }
        } else {
            const int ch = (pn - 12) * 64 + wc * 16 + 4 * fq;
#pragma unroll
            for (int ai = 0; ai < 2; ++ai)
#pragma unroll
                for (int m = 0; m < 4; ++m) { const int row = row0 + ai * HALF + m * 16;
                    const f32x4 cb = acc[ai][0][m][0], cc = acc[ai][0][m][1], cx = acc[ai][1][m][0], gc = acc[ai][1][m][1];
                    f32x4 uu = cc * cx, gt;
#pragma unroll
                    for (int j = 0; j < 4; ++j) gt[j] = cb[j] * silu_f(gc[j]);
                    u32x2 wg, wu; wg.x = cvtpk(gt[0], gt[1]); wg.y = cvtpk(gt[2], gt[3]); wu.x = cvtpk(uu[0], uu[1]); wu.y = cvtpk(uu[2], uu[3]);
                    *(u32x2*)(P + (size_t)row * PW + PGATE + ch) = wg; *(u32x2*)(P + (size_t)row * PW + PU + ch) = wu; }
        }
    }
};

struct EpiOddIn {
    static constexpr bool PERM = true;
    bf16_t* CQ; bf16_t* CKV; bf16_t* KR; bf16_t* SG; float* SS; const float* cosT; const float* sinT;
    __device__ __forceinline__ void operator()(const f32x4 (&acc)[2][2][4][2], const Unit& u, int wr, int wc, int fr, int fq) const {
        const int row0 = u.pm * BM + wr * 64 + fr;
#pragma unroll
        for (int bj = 0; bj < 2; ++bj) {
            const int c0 = u.pn * BM + bj * HALF + wc * 32 + 8 * fq, gi = c0 >> 6;
            if (gi < 10) {
                bf16_t* dst = gi < 6 ? CQ : CKV; const int ld = gi < 6 ? 384 : 256, cc = gi < 6 ? c0 : c0 - 384, slot = gi < 6 ? (c0 >> 5) : 16 + ((c0 - 384) >> 5);
#pragma unroll
                for (int ai = 0; ai < 2; ++ai)
#pragma unroll
                    for (int m = 0; m < 4; ++m) { const int row = row0 + ai * HALF + m * 16; const f32x4 a = acc[ai][bj][m][0], b = acc[ai][bj][m][1];
                        float s = (a[0] * a[0] + a[1] * a[1]) + (a[2] * a[2] + a[3] * a[3]) + (b[0] * b[0] + b[1] * b[1]) + (b[2] * b[2] + b[3] * b[3]);
                        s += __shfl_xor(s, 16); s += __shfl_xor(s, 32);
                        *(u32x4*)(dst + (size_t)row * ld + cc) = pack8(a, b);
                        if (fq == 0) SS[(size_t)row * SSW + slot] = s; }
            } else if (gi == 10) {
                const int dbase = (wc & 1) * 16 + 4 * fq;
#pragma unroll
                for (int ai = 0; ai < 2; ++ai)
#pragma unroll
                    for (int m = 0; m < 4; ++m) { const int row = row0 + ai * HALF + m * 16; const f32x4 a = acc[ai][bj][m][0], b = acc[ai][bj][m][1];
                        const f32x4 cs = *(const f32x4*)(cosT + (size_t)row * 32 + dbase), sn = *(const f32x4*)(sinT + (size_t)row * 32 + dbase);
                        *(u32x4*)(KR + (size_t)row * 64 + (c0 - 640)) = pack8(a * cs - b * sn, a * sn + b * cs); }
            } else if (gi < 27) {
#pragma unroll
                for (int ai = 0; ai < 2; ++ai)
#pragma unroll
                    for (int m = 0; m < 4; ++m) { const int row = row0 + ai * HALF + m * 16; f32x4 a = acc[ai][bj][m][0], b = acc[ai][bj][m][1];
#pragma unroll
                        for (int j = 0; j < 4; ++j) { a[j] = silu_f(a[j]); b[j] = silu_f(b[j]); }
                        *(u32x4*)(SG + (size_t)row * 1024 + (c0 - 704)) = pack8(a, b); }
            }
        }
    }
};

struct EpiQb {
    static constexpr bool PERM = true;
    bf16_t* Q; const float* SS; const float* cosT; const float* sinT;
    __device__ __forceinline__ void operator()(const f32x4 (&acc)[2][2][4][2], const Unit& u, int wr, int wc, int fr, int fq) const {
        const int row0 = u.pm * BM + wr * 64 + fr;
#pragma unroll
        for (int ai = 0; ai < 2; ++ai)
#pragma unroll
            for (int m = 0; m < 4; ++m) { const int row = row0 + ai * HALF + m * 16;
                f32x4 s0 = {0.f, 0.f, 0.f, 0.f}; if (fq < 3) s0 = *(const f32x4*)(SS + (size_t)row * SSW + 4 * fq);
                float ss = (s0[0] + s0[1]) + (s0[2] + s0[3]); ss += __shfl_xor(ss, 16); ss += __shfl_xor(ss, 32);
                const float rs = __builtin_amdgcn_rsqf(ss * (1.0f / 384.0f) + EPS) * QSCALE;
#pragma unroll
                for (int bj = 0; bj < 2; ++bj) { const int c0 = u.pn * BM + bj * HALF + wc * 32 + 8 * fq, gi = c0 >> 6;
                    f32x4 a = acc[ai][bj][m][0] * rs, b = acc[ai][bj][m][1] * rs;
                    if (gi % 3 == 2) { const int dbase = (wc & 1) * 16 + 4 * fq;
                        const f32x4 cs = *(const f32x4*)(cosT + (size_t)row * 32 + dbase), sn = *(const f32x4*)(sinT + (size_t)row * 32 + dbase);
                        const f32x4 o0 = a * cs - b * sn, o1 = a * sn + b * cs; a = o0; b = o1; }
                    *(u32x4*)(Q + (size_t)row * O_NQ + c0) = pack8(a, b); } }
    }
};

struct EpiKvb {
    static constexpr bool PERM = true;
    bf16_t* KN; bf16_t* V; const float* SS;
    __device__ __forceinline__ void operator()(const f32x4 (&acc)[2][2][4][2], const Unit& u, int wr, int wc, int fr, int fq) const {
        const int row0 = u.pm * BM + wr * 64 + fr;
#pragma unroll
        for (int ai = 0; ai < 2; ++ai)
#pragma unroll
            for (int m = 0; m < 4; ++m) { const int row = row0 + ai * HALF + m * 16;
                f32x4 s0 = {0.f, 0.f, 0.f, 0.f}; if (fq < 2) s0 = *(const f32x4*)(SS + (size_t)row * SSW + 16 + 4 * fq);
                float ss = (s0[0] + s0[1]) + (s0[2] + s0[3]); ss += __shfl_xor(ss, 16); ss += __shfl_xor(ss, 32);
                const float rs = __builtin_amdgcn_rsqf(ss * (1.0f / 256.0f) + EPS);
#pragma unroll
                for (int bj = 0; bj < 2; ++bj) { bf16_t* dst = bj == 0 ? KN : V;
                    *(u32x4*)(dst + (size_t)row * 1024 + u.pn * 128 + wc * 32 + 8 * fq) = pack8(acc[ai][bj][m][0] * rs, acc[ai][bj][m][1] * rs); } }
    }
};

struct EpiF32 {
    static constexpr bool PERM = false;
    float* C; int ldc;
    __device__ __forceinline__ void operator()(const f32x4 (&acc)[2][2][4][2], const Unit& u, int wr, int wc, int fr, int fq) const {
        const int row0 = u.pm * BM + wr * 64 + fr, col0 = u.pn * BM + wc * 32 + 4 * fq;
#pragma unroll
        for (int ai = 0; ai < 2; ++ai)
#pragma unroll
            for (int m = 0; m < 4; ++m) { float* rowp = C + (size_t)(row0 + ai * HALF + m * 16) * ldc + col0;
#pragma unroll
                for (int bj = 0; bj < 2; ++bj)
#pragma unroll
                    for (int n = 0; n < 2; ++n) *(f32x4*)(rowp + bj * HALF + n * 16) = acc[ai][bj][m][n]; }
    }
};
}

#define XB_TMO      128
#define XB_XCNT(j)  (256  + 64 * (j))
#define XB_XSUB(j)  (1280 + 64 * (j))
#define XB_XGEN(j)  (2304 + 64 * (j))
#define XB_TOP      3328
#define XB_TOPGEN   3392
#define XCD_BAR_WORDS 3456
#define XB_SPIN_CAP (1u << 21)

__device__ __forceinline__ unsigned xb_ld(unsigned* p)              { return __hip_atomic_load(p, __ATOMIC_RELAXED, __HIP_MEMORY_SCOPE_AGENT); }
__device__ __forceinline__ unsigned xb_add(unsigned* p, unsigned v) { return __hip_atomic_fetch_add(p, v, __ATOMIC_RELAXED, __HIP_MEMORY_SCOPE_AGENT); }
__device__ __forceinline__ unsigned xb_xcc_id() { return (unsigned)__builtin_amdgcn_s_getreg((3 << 11) | 20) & 0xFu; }
#define XB_SPIN(cond, bar) do { unsigned _sp = 0; while (cond) { __builtin_amdgcn_s_sleep(1); \
    if ((++_sp & 255u) == 0u) { if (xb_ld(&(bar)[XB_TMO])) break; if (_sp > XB_SPIN_CAP) { atomicAdd(&(bar)[XB_TMO], 1u); break; } } } } while (0)

struct XcdBarrier { unsigned* bar; unsigned x; volatile LAS unsigned* st; };

__device__ __forceinline__ XcdBarrier xcd_barrier_post(unsigned* bar, volatile LAS unsigned* st) {
    XcdBarrier b; b.bar = bar; b.x = xb_xcc_id(); b.st = st;
    if (threadIdx.x == 0) (void)xb_add(&bar[XB_XCNT(b.x)], 1u);
    return b;
}
__device__ __forceinline__ void xcd_barrier_complete(unsigned* bar, unsigned x, unsigned& nloc, unsigned& nx) {
    const unsigned G = gridDim.x * gridDim.y * gridDim.z;
    unsigned sum, cnt, mine, sp = 0u;
    for (;;) {
        sum = 0u; cnt = 0u; mine = 0u;
#pragma unroll
        for (unsigned j = 0; j < 16; ++j) { const unsigned c = xb_ld(&bar[XB_XCNT(j)]); sum += c; cnt += (c > 0u) ? 1u : 0u; mine = (j == x) ? c : mine; }
        if (sum == G) break;
        __builtin_amdgcn_s_sleep(1);
        if ((++sp & 255u) == 0u) { if (xb_ld(&bar[XB_TMO])) break; if (sp > XB_SPIN_CAP) { atomicAdd(&bar[XB_TMO], 1u); break; } }
    }
    nloc = mine > 0u ? mine : 1u; nx = cnt > 0u ? cnt : 1u;
}
__device__ __forceinline__ void xcd_barrier(const XcdBarrier& b) {
    asm volatile("s_waitcnt vmcnt(0)" ::: "memory");
    __syncthreads();
    if (threadIdx.x == 0) {
        unsigned* bar = b.bar;
        __builtin_amdgcn_s_waitcnt(0);
        unsigned nloc = b.st[0], nx = b.st[1];
        if (nloc == 0u) { xcd_barrier_complete(bar, b.x, nloc, nx); b.st[0] = nloc; b.st[1] = nx; }
        const unsigned old = xb_add(&bar[XB_XSUB(b.x)], 1u);
        const unsigned gen = old / nloc;
        if (old + 1u == (gen + 1u) * nloc) {
            __builtin_amdgcn_fence(__ATOMIC_RELEASE, "agent");
            asm volatile("s_waitcnt vmcnt(0)" ::: "memory");
            const unsigned og = xb_add(&bar[XB_TOP], 1u);
            const unsigned tg = og / nx;
            if (og + 1u == (tg + 1u) * nx) xb_add(&bar[XB_TOPGEN], 1u);
            else XB_SPIN(xb_ld(&bar[XB_TOPGEN]) == tg, bar);
            __builtin_amdgcn_fence(__ATOMIC_ACQUIRE, "agent");
            xb_add(&bar[XB_XGEN(b.x)], 1u);
            asm volatile("s_waitcnt vmcnt(0)" ::: "memory");
        } else {
            XB_SPIN(xb_ld(&bar[XB_XGEN(b.x)]) == gen, bar);
            __builtin_amdgcn_fence(__ATOMIC_ACQUIRE, "agent");
            asm volatile("s_waitcnt vmcnt(0)" ::: "memory");
        }
    }
    __syncthreads();
}

__device__ __forceinline__ s16x4 ds_tr(LAS const char* p) { return __builtin_bit_cast(s16x4, __builtin_amdgcn_ds_read_tr16_b64_v4i16((LAS v4i16*)p)); }
__device__ __forceinline__ bf16x8 tr_frag_nat(LAS const char* base, int pitch, int krow0, int col0, int lane) {
    const int h = lane >> 5, g1 = (lane >> 4) & 1, q = (lane & 15) >> 2, p = lane & 3;
    LAS const char* a = base + (krow0 + 8 * h + q) * pitch + (col0 + 16 * g1 + 4 * p) * 2;
    const s16x4 lo = ds_tr(a), hi = ds_tr(a + 4 * pitch);
    return (bf16x8){lo[0], lo[1], lo[2], lo[3], hi[0], hi[1], hi[2], hi[3]};
}
__device__ __forceinline__ bf16x8 tr_frag_perm(LAS const char* base, int pitch, int krow0, int col0, int lane) {
    const int h = lane >> 5, g1 = (lane >> 4) & 1, q = (lane & 15) >> 2, p = lane & 3;
    LAS const char* a = base + (krow0 + 4 * h + q) * pitch + (col0 + 16 * g1 + 4 * p) * 2;
    const s16x4 lo = ds_tr(a), hi = ds_tr(a + 8 * pitch);
    return (bf16x8){lo[0], lo[1], lo[2], lo[3], hi[0], hi[1], hi[2], hi[3]};
}
__device__ __forceinline__ bf16x8 pack_acc8(const f32x16& x, int s) {
    u32x4 w; w.x = cvtpk(x[8 * s + 0], x[8 * s + 1]); w.y = cvtpk(x[8 * s + 2], x[8 * s + 3]); w.z = cvtpk(x[8 * s + 4], x[8 * s + 5]); w.w = cvtpk(x[8 * s + 6], x[8 * s + 7]);
    return __builtin_bit_cast(bf16x8, w);
}

struct Args { const float* in[15]; float* out; unsigned char* ws; int ph_lo, ph_hi, nlayers, pad; };
enum { I_X = 0, I_POS, I_PRE, I_POST, I_EWIN, I_ECW, I_ECB, I_GN, I_EWOUT, I_OWIN, I_QAN, I_WQB, I_KVAN, I_WKVB, I_OWOUT };

__device__ __forceinline__ int wmap(int mt, int p) {
    if (mt == 0) {
        const int tile = p >> 8;
        if (tile < 4) return (p & ~63) + rope_d(p & 63);
        if (tile < 12) return p;
        const int w = p & 255, bj = (w >> 7) & 1, wc = (w >> 5) & 3, fq = (w >> 3) & 3, n = (w >> 2) & 1, j = w & 3;
        return 3072 + 1024 * (2 * bj + n) + 64 * (tile - 12) + 16 * wc + 4 * fq + j;
    } else if (mt == 2) {
        if (p >= 1728) return -1;
        if (p >= 640 && p < 704) return 640 + rope_d(p - 640);
        return p;
    } else if (mt == 3) {
        const int blk = p >> 6;
        if (blk % 3 == 2) return (p & ~63) + rope_d(p & 63);
        return p;
    }
    return p;
}
__device__ __forceinline__ void wt_item(const float* W, int K, int N, bf16_t* WT, int nblk, int mt, const float* kscale, LAS float* scr, int item, int lane) {
    const int kb = item / nblk, nb = item % nblk, k0 = 64 * kb, p0 = 32 * nb;
    const int src = wmap(mt, p0 + (lane & 31));
#pragma unroll 8
    for (int i = 0; i < 32; ++i) { const int kk = 2 * i + (lane >> 5); float v = src >= 0 ? W[(size_t)(k0 + kk) * N + src] : 0.f; if (kscale) v *= kscale[k0 + kk]; scr[kk * 33 + (lane & 31)] = v; }
    LDS_WAIT(); asm volatile("" ::: "memory");
    const int c = lane & 7;
#pragma unroll
    for (int j = 0; j < 4; ++j) { const int n = (lane >> 3) + 8 * j; const LAS float* s = scr + (8 * c) * 33 + n;
        u32x4 o; o.x = cvtpk(s[0 * 33], s[1 * 33]); o.y = cvtpk(s[2 * 33], s[3 * 33]); o.z = cvtpk(s[4 * 33], s[5 * 33]); o.w = cvtpk(s[6 * 33], s[7 * 33]);
        *(u32x4*)(WT + (size_t)(p0 + n) * K + k0 + 8 * c) = o; }
    LDS_WAIT(); asm volatile("" ::: "memory");
}
__device__ __forceinline__ void norm_row_to_bf16(const float* xrow, const float* gain, bf16_t* orow, int lane) {
    f32x4 v[4]; float s = 0.f;
#pragma unroll
    for (int j = 0; j < 4; ++j) { v[j] = *(const f32x4*)(xrow + 4 * lane + 256 * j); s += (v[j][0] * v[j][0] + v[j][1] * v[j][1]) + (v[j][2] * v[j][2] + v[j][3] * v[j][3]); }
    const float rs = __builtin_amdgcn_rsqf(wave_sum(s) * (1.f / DM) + EPS);
#pragma unroll
    for (int j = 0; j < 4; ++j) { const f32x4 g = *(const f32x4*)(gain + 4 * lane + 256 * j); const f32x4 o = v[j] * rs * g;
        u32x2 w; w.x = cvtpk(o[0], o[1]); w.y = cvtpk(o[2], o[3]); *(u32x2*)(orow + 4 * lane + 256 * j) = w; }
}

constexpr int NWAVES = 8;
constexpr int NPHASES = 23;
#ifndef PMASK
#define PMASK 0xfff
#endif
#define PON(k) ((PMASK >> (k)) & 1)

__global__ void __launch_bounds__(NWAVES * 64, 2) trunk_fwd(Args args) {
    extern __shared__ __attribute__((aligned(16))) unsigned char lds_raw[];
    LAS unsigned char* lds = (LAS unsigned char*)lds_raw;
    LAS char* ldc = (LAS char*)lds_raw;
    volatile LAS unsigned* MISC = (volatile LAS unsigned*)(lds + MISC_OFF);
    const int G = gridDim.x, bx = blockIdx.x;
    const int vcu = (G % 8 == 0) ? (bx % 8) * (G / 8) + bx / 8 : bx;
    unsigned char* ws = args.ws;
    unsigned* ctl = (unsigned*)(ws + WS_CTL);
    float* cosT = (float*)(ws + WS_COS); float* sinT = (float*)(ws + WS_SIN);
    bf16_t* UN = (bf16_t*)(ws + WS_UN);
    unsigned char* BIG = ws + WS_BIG;
    const int lo = args.ph_lo, hi = args.ph_hi, NL = args.nlayers;

    for (int u = threadIdx.x; u < (LDS_BYTES - RING_BYTES) / 4; u += NWAVES * 64) ((LAS unsigned*)(lds + RING_BYTES))[u] = 0u;
    __syncthreads();
    XcdBarrier bar = xcd_barrier_post(ctl + CW_BAR, MISC + 8);
#define RUN(id) (lo <= (id) && (id) < hi)
#define SEAM(id) do { if (RUN(id) && RUN((id) + 1)) xcd_barrier(bar); } while (0)
#define PHASE_IDS() const int tid = otid(), lane = tid & 63, wave = __builtin_amdgcn_readfirstlane(tid >> 6); const int gw = vcu * NWAVES + wave, NGW = G * NWAVES, gt = vcu * (NWAVES * 64) + tid, NGT = G * NWAVES * 64; (void)lane; (void)gw; (void)NGW; (void)gt; (void)NGT

    if (PON(0) && RUN(0)) {
                PHASE_IDS();
        LAS float* scr = (LAS float*)(lds + wave * 16384);
        constexpr int I0 = 16 * 224, I1 = 32 * 32, I2 = 16 * 56, I3 = 6 * 48, I4 = 4 * 64, I5 = 16 * 32, IL = I0 + I1 + I2 + I3 + I4 + I5;
        for (int it = gw; it < 2 * IL; it += NGW) {
            const int li = it / IL; int r = it - li * IL;
            unsigned char* wb = ws + WS_W + (size_t)li * W_LAYER;
            if (r < I0) { wt_item(args.in[I_EWIN] + (size_t)li * 1024 * 7168, 1024, 7168, (bf16_t*)(wb + W_EIN), 224, 0, nullptr, scr, r, lane); continue; } r -= I0;
            if (r < I1) { wt_item(args.in[I_EWOUT] + (size_t)li * 2048 * 1024, 2048, 1024, (bf16_t*)(wb + W_EOUT), 32, 1, nullptr, scr, r, lane); continue; } r -= I1;
            if (r < I2) { wt_item(args.in[I_OWIN] + (size_t)li * 1024 * 1728, 1024, 1728, (bf16_t*)(wb + W_OIN), 56, 2, nullptr, scr, r, lane); continue; } r -= I2;
            if (r < I3) { wt_item(args.in[I_WQB] + (size_t)li * 384 * 1536, 384, 1536, (bf16_t*)(wb + W_OQB), 48, 3, args.in[I_QAN] + li * 384, scr, r, lane); continue; } r -= I3;
            if (r < I4) { wt_item(args.in[I_WKVB] + (size_t)li * 256 * 2048, 256, 2048, (bf16_t*)(wb + W_OKVB), 64, 1, args.in[I_KVAN] + li * 256, scr, r, lane); continue; } r -= I4;
            wt_item(args.in[I_OWOUT] + (size_t)li * 1024 * 1024, 1024, 1024, (bf16_t*)(wb + W_OOUT), 32, 1, nullptr, scr, r, lane);
        }
        const int* pos = (const int*)args.in[I_POS];
        for (int e = gt; e < T * 32; e += NGT) { const int t = e >> 5, i = e & 31;
            const float inv = powf(10000.0f, -(float)i * (1.0f / 32.0f)); const float ang = (float)pos[t] * inv;
            cosT[e] = cosf(ang); sinT[e] = sinf(ang); }
        for (int m = gw; m < T; m += NGW) norm_row_to_bf16(args.in[I_X] + (size_t)m * DM, args.in[I_PRE], UN + (size_t)m * DM, lane);
    }
    SEAM(0);

    for (int l = 0; l < 4; ++l) {
        const int li = l >> 1, pb = 1 + 11 * li + 6 * (l & 1);
        if (l >= NL) break;
        unsigned char* wb = ws + WS_W + (size_t)li * W_LAYER;
        const bf16_t* outA; int outK, outLda; const bf16_t* outW; float* Y; int ldy; int po;
        if ((l & 1) == 0) {
            bf16_t* P = (bf16_t*)BIG; float* ST = (float*)(ws + WS_UN);
            if (PON(1) && RUN(pb + 0)) {
                pg8::Gemm g{UN, (const bf16_t*)(wb + W_EIN), T, E_NIN, 1024, 1024}; pg8::StaticOrder S; S.init(T, E_NIN, G, bx);
                pg8::EpiEvenIn E{P, cosT, sinT};
                pg8::gemm_phase<pg8::EpiEvenIn, pg8::StaticOrder, true>(lds, g, S, E);
            }
            SEAM(pb + 0);
            if (PON(2) && RUN(pb + 1)) {
                PHASE_IDS();
                LAS char* kL = ldc; LAS char* vL = ldc + 128 * 192;
                for (int unit = vcu; unit < 1024; unit += G) {
                    const int h = unit & 7, n = (unit >> 3) & 31, b = unit >> 8; const size_t row0 = (size_t)b * SEQ + n * 128;
                    const float lg2 = log2f(1.0f - exp2f(-5.0f - (float)h));
#pragma unroll
                    for (int i = 0; i < 2; ++i) { const int c = tid + 512 * i, r = c >> 3, ch = c & 7;
                        const u32x4 w = *(const u32x4*)(P + (row0 + r) * PW + PK + 64 * h + 8 * ch); const float z = exp2f(lg2 * (float)(127 - r));
                        u32x4 o; o.x = cvtpk(bflo(w.x) * z, bfhi(w.x) * z); o.y = cvtpk(bflo(w.y) * z, bfhi(w.y) * z); o.z = cvtpk(bflo(w.z) * z, bfhi(w.z) * z); o.w = cvtpk(bflo(w.w) * z, bfhi(w.w) * z);
                        *(LAS u32x4*)(kL + r * 192 + 16 * ch) = o; }
#pragma unroll
                    for (int i = 0; i < 4; ++i) { const int c = tid + 512 * i, r = c >> 4, ch = c & 15;
                        *(LAS u32x4*)(vL + r * 320 + 16 * ch) = *(const u32x4*)(P + (row0 + r) * PW + PV + 128 * h + 8 * ch); }
                    __syncthreads();
                    const int db = wave & 1, eb = wave >> 1; f32x16 acc = {};
#pragma unroll
                    for (int s = 0; s < 8; ++s) { const bf16x8 a = tr_frag_nat(kL, 192, 16 * s, 32 * db, lane), bb = tr_frag_nat(vL, 320, 16 * s, 32 * eb, lane);
                        acc = __builtin_amdgcn_mfma_f32_32x32x16_bf16(a, bb, acc, 0, 0, 0); }
                    float* So = ST + (size_t)unit * 8192;
#pragma unroll
                    for (int r = 0; r < 16; ++r) So[(32 * db + crow(r, lane >> 5)) * 128 + 32 * eb + (lane & 31)] = acc[r];
                    __syncthreads();
                }
            }
            SEAM(pb + 1);
            if (PON(3) && RUN(pb + 2)) {
                PHASE_IDS();
                if (gt < NBATCH * 8 * 2048) {
                    const int e4 = gt & 2047, h = (gt >> 11) & 7, b = gt >> 14;
                    const float gc = exp2f(128.0f * log2f(1.0f - exp2f(-5.0f - (float)h)));
                    float z0 = 0.f; asm volatile("" : "+v"(z0));
                    f32x4 run = {z0, z0, z0, z0};
                    for (int n0 = 0; n0 < 32; n0 += 8) { f32x4 tmp[8];
#pragma unroll
                        for (int i = 0; i < 8; ++i) tmp[i] = *(const f32x4*)(ST + ((size_t)((b * 32 + n0 + i) * 8 + h)) * 8192 + 4 * e4);
#pragma unroll
                        for (int i = 0; i < 8; ++i) { *(f32x4*)(ST + ((size_t)((b * 32 + n0 + i) * 8 + h)) * 8192 + 4 * e4) = run; run = run * gc + tmp[i]; } }
                }
                const float* cw = args.in[I_ECW] + li * 3 * 1024; const float* cbias = args.in[I_ECB] + li * 1024;
                for (int e = gt; e < T * 128; e += NGT) { const int t = e >> 7, c = (e & 127) * 8, s = t & (SEQ - 1);
                    const u32x4 g = *(const u32x4*)(P + (size_t)t * PW + PGATE + c), u0 = *(const u32x4*)(P + (size_t)t * PW + PU + c);
                    u32x4 u1 = {0u, 0u, 0u, 0u}, u2 = {0u, 0u, 0u, 0u};
                    if (s >= 1) u1 = *(const u32x4*)(P + (size_t)(t - 1) * PW + PU + c);
                    if (s >= 2) u2 = *(const u32x4*)(P + (size_t)(t - 2) * PW + PU + c);
                    const f32x4 w0a = *(const f32x4*)(cw + c), w0b = *(const f32x4*)(cw + c + 4), w1a = *(const f32x4*)(cw + 1024 + c), w1b = *(const f32x4*)(cw + 1024 + c + 4);
                    const f32x4 w2a = *(const f32x4*)(cw + 2048 + c), w2b = *(const f32x4*)(cw + 2048 + c + 4), ba = *(const f32x4*)(cbias + c), bb = *(const f32x4*)(cbias + c + 4);
                    u32x4 o;
                    { const float o0 = bflo(g.x) * (w0a[0] * bflo(u2.x) + w1a[0] * bflo(u1.x) + w2a[0] * bflo(u0.x) + ba[0]);
                      const float o1 = bfhi(g.x) * (w0a[1] * bfhi(u2.x) + w1a[1] * bfhi(u1.x) + w2a[1] * bfhi(u0.x) + ba[1]);
                      const float o2 = bflo(g.y) * (w0a[2] * bflo(u2.y) + w1a[2] * bflo(u1.y) + w2a[2] * bflo(u0.y) + ba[2]);
                      const float o3 = bfhi(g.y) * (w0a[3] * bfhi(u2.y) + w1a[3] * bfhi(u1.y) + w2a[3] * bfhi(u0.y) + ba[3]);
                      const float o4 = bflo(g.z) * (w0b[0] * bflo(u2.z) + w1b[0] * bflo(u1.z) + w2b[0] * bflo(u0.z) + bb[0]);
                      const float o5 = bfhi(g.z) * (w0b[1] * bfhi(u2.z) + w1b[1] * bfhi(u1.z) + w2b[1] * bfhi(u0.z) + bb[1]);
                      const float o6 = bflo(g.w) * (w0b[2] * bflo(u2.w) + w1b[2] * bflo(u1.w) + w2b[2] * bflo(u0.w) + bb[2]);
                      const float o7 = bfhi(g.w) * (w0b[3] * bfhi(u2.w) + w1b[3] * bfhi(u1.w) + w2b[3] * bfhi(u0.w) + bb[3]);
                      o.x = cvtpk(o0, o1); o.y = cvtpk(o2, o3); o.z = cvtpk(o4, o5); o.w = cvtpk(o6, o7); }
                    *(u32x4*)(P + (size_t)t * PW + PGATE + c) = o; }
            }
            SEAM(pb + 2);
            if (PON(4) && RUN(pb + 3)) {
                PHASE_IDS();
                LAS char* qL = ldc; LAS char* kL = ldc + 18432; LAS char* vL = ldc + 36864; LAS char* pL = ldc + 77824; LAS float* ssL = (LAS float*)(ldc + 98304);
                const float* gn = args.in[I_GN] + li * 1024;
                for (int unit = vcu; unit < 1024; unit += G) {
                    const int h = unit & 7, n = (unit >> 3) & 31, b = unit >> 8; const size_t row0 = (size_t)b * SEQ + n * 128;
                    const float lg2 = log2f(1.0f - exp2f(-5.0f - (float)h));
#pragma unroll
                    for (int i = 0; i < 2; ++i) { const int c = tid + 512 * i, r = c >> 3, ch = c & 7;
                        *(LAS u32x4*)(qL + r * 144 + 16 * ch) = *(const u32x4*)(P + (row0 + r) * PW + PQ + 64 * h + 8 * ch);
                        *(LAS u32x4*)(kL + r * 144 + 16 * ch) = *(const u32x4*)(P + (row0 + r) * PW + PK + 64 * h + 8 * ch); }
#pragma unroll
                    for (int i = 0; i < 4; ++i) { const int c = tid + 512 * i, r = c >> 4, ch = c & 15;
                        *(LAS u32x4*)(vL + r * 320 + 16 * ch) = *(const u32x4*)(P + (row0 + r) * PW + PV + 128 * h + 8 * ch); }
#pragma unroll
                    for (int i = 0; i < 2; ++i) { const int c = tid + 512 * i, r = c >> 4, ch = c & 15; const float* sp = ST + (size_t)unit * 8192 + r * 128 + 8 * ch;
                        *(LAS u32x4*)(pL + r * 320 + 16 * ch) = pg8::pack8(*(const f32x4*)sp, *(const f32x4*)(sp + 4)); }
                    __syncthreads();
                    const int ib = wave & 3, eh = wave >> 2, r32 = lane & 31, hh = lane >> 5, iloc = 32 * ib + r32;
                    bf16x8 qf[4];
#pragma unroll
                    for (int s = 0; s < 4; ++s) qf[s] = *(const LAS bf16x8*)(qL + iloc * 144 + (16 * s + 8 * hh) * 2);
                    f32x16 YT[2] = {}, CT[2] = {};
                    for (int jb = 0; jb <= ib; ++jb) {
                        f32x16 X = {};
#pragma unroll
                        for (int s = 0; s < 4; ++s) { const bf16x8 kf = *(const LAS bf16x8*)(kL + (32 * jb + r32) * 144 + (16 * s + 8 * hh) * 2);
                            X = __builtin_amdgcn_mfma_f32_32x32x16_bf16(kf, qf[s], X, 0, 0, 0); }
#pragma unroll
                        for (int r = 0; r < 16; ++r) { const int j = 32 * jb + crow(r, hh); const float f = exp2f(lg2 * (float)(iloc - j)); X[r] = (iloc >= j) ? X[r] * f : 0.f; }
                        const bf16x8 pa0 = pack_acc8(X, 0), pa1 = pack_acc8(X, 1);
#pragma unroll
                        for (int e2 = 0; e2 < 2; ++e2) {
                            const bf16x8 v0 = tr_frag_perm(vL, 320, 32 * jb, 64 * eh + 32 * e2, lane), v1 = tr_frag_perm(vL, 320, 32 * jb + 16, 64 * eh + 32 * e2, lane);
                            YT[e2] = __builtin_amdgcn_mfma_f32_32x32x16_bf16(v0, pa0, YT[e2], 0, 0, 0);
                            YT[e2] = __builtin_amdgcn_mfma_f32_32x32x16_bf16(v1, pa1, YT[e2], 0, 0, 0); }
                    }
#pragma unroll
                    for (int s = 0; s < 4; ++s)
#pragma unroll
                        for (int e2 = 0; e2 < 2; ++e2) { const bf16x8 pf = tr_frag_nat(pL, 320, 16 * s, 64 * eh + 32 * e2, lane);
                            CT[e2] = __builtin_amdgcn_mfma_f32_32x32x16_bf16(pf, qf[s], CT[e2], 0, 0, 0); }
                    const float xi = exp2f(lg2 * (float)(iloc + 1));
                    float ss = 0.f;
#pragma unroll
                    for (int e2 = 0; e2 < 2; ++e2)
#pragma unroll
                        for (int r = 0; r < 16; ++r) { YT[e2][r] += xi * CT[e2][r]; ss += YT[e2][r] * YT[e2][r]; }
                    ss += __shfl_xor(ss, 32);
                    if (hh == 0) ssL[eh * 128 + iloc] = ss;
                    __syncthreads();
                    const float rs = __builtin_amdgcn_rsqf((ssL[iloc] + ssL[128 + iloc]) * (1.0f / 128.0f) + EPS);
#pragma unroll
                    for (int e2 = 0; e2 < 2; ++e2)
#pragma unroll
                        for (int r4 = 0; r4 < 4; ++r4) { const int e = 64 * eh + 32 * e2 + 8 * r4 + 4 * hh;
                            bf16_t* gp = P + (row0 + iloc) * PW + PSG + 128 * h + e; const u32x2 sg = *(const u32x2*)gp; const f32x4 gg = *(const f32x4*)(gn + 128 * h + e);
                            u32x2 o; o.x = cvtpk(YT[e2][4 * r4 + 0] * rs * gg[0] * bflo(sg.x), YT[e2][4 * r4 + 1] * rs * gg[1] * bfhi(sg.x));
                            o.y = cvtpk(YT[e2][4 * r4 + 2] * rs * gg[2] * bflo(sg.y), YT[e2][4 * r4 + 3] * rs * gg[3] * bfhi(sg.y));
                            *(u32x2*)gp = o; }
                    __syncthreads();
                }
            }
            SEAM(pb + 3);
            outA = P + PSG; outK = 2048; outLda = PW; outW = (const bf16_t*)(wb + W_EOUT); Y = (float*)BIG; ldy = 2560; po = pb + 4;
        } else {
            bf16_t* SG = (bf16_t*)(BIG + B_SG); bf16_t* Q = (bf16_t*)(BIG + B_Q); bf16_t* V = (bf16_t*)(BIG + B_V); bf16_t* CQ = (bf16_t*)(BIG + B_CQ);
            bf16_t* CKV = (bf16_t*)(BIG + B_CKV); bf16_t* KR = (bf16_t*)(BIG + B_KR); float* SS = (float*)(BIG + B_SS); bf16_t* KN = (bf16_t*)(ws + WS_UN);
            if (PON(5) && RUN(pb + 0)) {
                pg8::Gemm g{UN, (const bf16_t*)(wb + W_OIN), T, O_NIN, 1024, 1024}; pg8::StaticOrder S; S.init(T, O_NIN, G, bx);
                pg8::EpiOddIn E{CQ, CKV, KR, SG, SS, cosT, sinT};
                pg8::gemm_phase<pg8::EpiOddIn, pg8::StaticOrder, true>(lds, g, S, E);
            }
            SEAM(pb + 0);
            if (PON(6) && RUN(pb + 1)) {
                if (PON(10)) { pg8::Gemm g{CQ, (const bf16_t*)(wb + W_OQB), T, O_NQ, 384, 384}; pg8::StaticOrder S; S.init(T, O_NQ, G, bx);
                  pg8::EpiQb E{Q, SS, cosT, sinT};
                  pg8::gemm_phase<pg8::EpiQb, pg8::StaticOrder, true>(lds, g, S, E); }
                __syncthreads();
                if (PON(11)) { pg8::Gemm g{CKV, (const bf16_t*)(wb + W_OKVB), T, O_NKV, 256, 256}; pg8::StaticOrder S; S.init(T, O_NKV, G, G - 1 - bx);
                  pg8::EpiKvb E{KN, V, SS};
                  pg8::gemm_phase<pg8::EpiKvb, pg8::StaticOrder, true>(lds, g, S, E); }
            }
            SEAM(pb + 1);
            if (PON(7) && RUN(pb + 2)) {
                PHASE_IDS();
                constexpr int KP = 400, VP = 320, KB = 64 * KP, VB = 64 * VP, STG = KB + VB;
                const int r32 = lane & 31, hh = lane >> 5;
                for (int item = vcu; item < 256; item += G) {
                    const int bh = item >> 3, x = item & 7, b = bh >> 3, h = bh & 7;
                    for (int pass = 0; pass < 2; ++pass) {
                        const int qb = pass ? 15 - x : x, NT = 4 * (qb + 1);
                        const size_t rowq = (size_t)b * SEQ + qb * 256 + wave * 32 + r32;
                        const int qpos = qb * 256 + wave * 32 + r32;
                        bf16x8 qf[8];
#pragma unroll
                        for (int s = 0; s < 8; ++s) qf[s] = *(const bf16x8*)(Q + rowq * O_NQ + h * 192 + 16 * s + 8 * hh);
                        LAS char* qrL = ldc + 2 * STG + wave * 4608 + r32 * 144 + 16 * hh;
#pragma unroll
                        for (int s = 0; s < 4; ++s) *(LAS bf16x8*)(qrL + 32 * s) = *(const bf16x8*)(Q + rowq * O_NQ + h * 192 + 128 + 16 * s + 8 * hh);
                        f32x16 OT[4] = {}; float m = -1e30f, l = 0.f;
                        u32x4 sk0, sk1, skr, sv0, sv1;
                        const size_t kb0 = (size_t)b * SEQ;
#define ALOAD(jt) do { const size_t kr_ = kb0 + (size_t)(jt) * 64; \
                            sk0 = *(const u32x4*)(KN + (kr_ + (tid >> 4)) * 1024 + 128 * h + 8 * (tid & 15)); sk1 = *(const u32x4*)(KN + (kr_ + 32 + (tid >> 4)) * 1024 + 128 * h + 8 * (tid & 15)); \
                            skr = *(const u32x4*)(KR + (kr_ + (tid >> 3)) * 64 + 8 * (tid & 7)); \
                            sv0 = *(const u32x4*)(V + (kr_ + (tid >> 4)) * 1024 + 128 * h + 8 * (tid & 15)); sv1 = *(const u32x4*)(V + (kr_ + 32 + (tid >> 4)) * 1024 + 128 * h + 8 * (tid & 15)); } while (0)
#define AWRITE(buf) do { LAS char* kd_ = ldc + (buf) * STG; LAS char* vd_ = kd_ + KB; \
                            *(LAS u32x4*)(kd_ + (tid >> 4) * KP + 16 * (tid & 15)) = sk0; *(LAS u32x4*)(kd_ + (32 + (tid >> 4)) * KP + 16 * (tid & 15)) = sk1; \
                            *(LAS u32x4*)(kd_ + (tid >> 3) * KP + 256 + 16 * (tid & 7)) = skr; \
                            *(LAS u32x4*)(vd_ + (tid >> 4) * VP + 16 * (tid & 15)) = sv0; *(LAS u32x4*)(vd_ + (32 + (tid >> 4)) * VP + 16 * (tid & 15)) = sv1; } while (0)
                        ALOAD(0); AWRITE(0);
                        __syncthreads();
                        for (int jt = 0; jt < NT; ++jt) {
                            const int buf = jt & 1;
                            if (jt + 1 < NT) ALOAD(jt + 1);
                            LAS const char* kL = ldc + buf * STG; LAS const char* vL = kL + KB;
                            f32x16 S0 = {}, S1 = {};
#pragma unroll
                            for (int s = 0; s < 12; ++s) {
                                const bf16x8 k0 = *(const LAS bf16x8*)(kL + r32 * KP + (16 * s + 8 * hh) * 2), k1 = *(const LAS bf16x8*)(kL + (32 + r32) * KP + (16 * s + 8 * hh) * 2);
                                const bf16x8 qq = s < 8 ? qf[s < 8 ? s : 0] : *(const LAS bf16x8*)(qrL + 32 * (s - 8));
                                S0 = __builtin_amdgcn_mfma_f32_32x32x16_bf16(k0, qq, S0, 0, 0, 0);
                                S1 = __builtin_amdgcn_mfma_f32_32x32x16_bf16(k1, qq, S1, 0, 0, 0); }
                            if (jt >= NT - 4) { const int kb_ = jt * 64; const float NEG = -__builtin_inff();
#pragma unroll
                                for (int r = 0; r < 16; ++r) { const int key = kb_ + crow(r, hh); if (key > qpos) S0[r] = NEG; if (key + 32 > qpos) S1[r] = NEG; } }
                            float mx = S0[0];
#pragma unroll
                            for (int r = 1; r < 16; ++r) mx = fmaxf(mx, S0[r]);
#pragma unroll
                            for (int r = 0; r < 16; ++r) mx = fmaxf(mx, S1[r]);
                            mx = fmaxf(mx, __shfl_xor(mx, 32));
                            const float mn = fmaxf(m, mx), alpha = __builtin_amdgcn_exp2f(m - mn); m = mn;
                            float ps = 0.f;
#pragma unroll
                            for (int r = 0; r < 16; ++r) { S0[r] = __builtin_amdgcn_exp2f(S0[r] - mn); S1[r] = __builtin_amdgcn_exp2f(S1[r] - mn); ps += S0[r] + S1[r]; }
                            l = l * alpha + ps;
#pragma unroll
                            for (int e = 0; e < 4; ++e)
#pragma unroll
                                for (int r = 0; r < 16; ++r) OT[e][r] *= alpha;
                            const bf16x8 pa00 = pack_acc8(S0, 0), pa01 = pack_acc8(S0, 1), pa10 = pack_acc8(S1, 0), pa11 = pack_acc8(S1, 1);
#pragma unroll
                            for (int e = 0; e < 4; ++e) {
                                OT[e] = __builtin_amdgcn_mfma_f32_32x32x16_bf16(tr_frag_perm(vL, VP, 0, 32 * e, lane), pa00, OT[e], 0, 0, 0);
                                OT[e] = __builtin_amdgcn_mfma_f32_32x32x16_bf16(tr_frag_perm(vL, VP, 16, 32 * e, lane), pa01, OT[e], 0, 0, 0);
                                OT[e] = __builtin_amdgcn_mfma_f32_32x32x16_bf16(tr_frag_perm(vL, VP, 32, 32 * e, lane), pa10, OT[e], 0, 0, 0);
                                OT[e] = __builtin_amdgcn_mfma_f32_32x32x16_bf16(tr_frag_perm(vL, VP, 48, 32 * e, lane), pa11, OT[e], 0, 0, 0); }
                            if (jt + 1 < NT) AWRITE(buf ^ 1);
                            __syncthreads();
                        }
#undef ALOAD
#undef AWRITE
                        l += __shfl_xor(l, 32);
                        const float rl = 1.0f / l;
#pragma unroll
                        for (int e = 0; e < 4; ++e)
#pragma unroll
                            for (int r4 = 0; r4 < 4; ++r4) { bf16_t* gp = SG + rowq * 1024 + 128 * h + 32 * e + 8 * r4 + 4 * hh; const u32x2 sg = *(const u32x2*)gp;
                                u32x2 o; o.x = cvtpk(OT[e][4 * r4 + 0] * rl * bflo(sg.x), OT[e][4 * r4 + 1] * rl * bfhi(sg.x));
                                o.y = cvtpk(OT[e][4 * r4 + 2] * rl * bflo(sg.y), OT[e][4 * r4 + 3] * rl * bfhi(sg.y));
                                *(u32x2*)gp = o; }
                    }
                }
            }
            SEAM(pb + 2);
            outA = SG; outK = 1024; outLda = 1024; outW = (const bf16_t*)(wb + W_OOUT); Y = (float*)(BIG + B_Q); ldy = 1024; po = pb + 3;
        }
        if (PON(8) && RUN(po)) {
            pg8::Gemm g{outA, outW, T, 1024, outK, outLda}; pg8::StaticOrder S; S.init(T, 1024, G, bx);
            pg8::EpiF32 E{Y, ldy};
            pg8::gemm_phase<pg8::EpiF32, pg8::StaticOrder, true>(lds, g, S, E);
        }
        SEAM(po);
        if (PON(9) && RUN(po + 1)) {
                PHASE_IDS();
            const float* hprev = (l == 0) ? args.in[I_X] : args.out; const float* postg = args.in[I_POST] + l * 1024; const float* preg = args.in[I_PRE] + (l + 1) * 1024;
            for (int mrow = gw; mrow < T; mrow += NGW) {
                const float* yr = Y + (size_t)mrow * ldy; f32x4 v[4]; float s = 0.f;
#pragma unroll
                for (int j = 0; j < 4; ++j) { v[j] = *(const f32x4*)(yr + 4 * lane + 256 * j); s += (v[j][0] * v[j][0] + v[j][1] * v[j][1]) + (v[j][2] * v[j][2] + v[j][3] * v[j][3]); }
                const float rs = __builtin_amdgcn_rsqf(wave_sum(s) * (1.f / DM) + EPS); float s2 = 0.f;
#pragma unroll
                for (int j = 0; j < 4; ++j) { const f32x4 g4 = *(const f32x4*)(postg + 4 * lane + 256 * j), hp = *(const f32x4*)(hprev + (size_t)mrow * DM + 4 * lane + 256 * j);
                    v[j] = hp + v[j] * rs * g4; *(f32x4*)(args.out + (size_t)mrow * DM + 4 * lane + 256 * j) = v[j];
                    s2 += (v[j][0] * v[j][0] + v[j][1] * v[j][1]) + (v[j][2] * v[j][2] + v[j][3] * v[j][3]); }
                if (l < 3) { const float rs2 = __builtin_amdgcn_rsqf(wave_sum(s2) * (1.f / DM) + EPS);
#pragma unroll
                    for (int j = 0; j < 4; ++j) { const f32x4 g4 = *(const f32x4*)(preg + 4 * lane + 256 * j); const f32x4 o = v[j] * rs2 * g4;
                        u32x2 w; w.x = cvtpk(o[0], o[1]); w.y = cvtpk(o[2], o[3]); *(u32x2*)(UN + (size_t)mrow * DM + 4 * lane + 256 * j) = w; } }
            }
        }
        if (l < 3) SEAM(po + 1);
    }
    if (NL == 0 && lo == 0 && hi == NPHASES) { for (int i = 0; i < 22; ++i) xcd_barrier(bar); }
    if (NL == 0 && RUN(NPHASES - 1)) {
        PHASE_IDS();
        for (int e = gt; e < T * DM / 4; e += NGT) ((f32x4*)args.out)[e] = ((const f32x4*)args.in[I_X])[e];
    }
#undef RUN
#undef SEAM
}

#ifndef NLAYERS
#define NLAYERS 4
#endif
#ifndef MULTI_LAUNCH
#define MULTI_LAUNCH 0
#endif
extern "C" void kernel_launch(void* const* d_in, const int* in_sizes, int n_in, void* d_out, int out_size, void* d_ws, size_t ws_size, hipStream_t stream) {
    static int grid = 0;
    if (grid == 0) {
        if (n_in != 15 || in_sizes[0] != T * DM || out_size != T * DM || ws_size < WS_END) { fprintf(stderr, "kernel_launch: unexpected shapes / workspace (%d inputs, ws %zu)\n", n_in, ws_size); grid = -1; return; }
        int dev = 0, cus = 0;
        if (hipGetDevice(&dev) != hipSuccess || hipDeviceGetAttribute(&cus, hipDeviceAttributeMultiprocessorCount, dev) != hipSuccess) { grid = -1; return; }
        if (hipFuncSetAttribute((const void*)trunk_fwd, hipFuncAttributeMaxDynamicSharedMemorySize, LDS_BYTES) != hipSuccess) { fprintf(stderr, "kernel_launch: hipFuncSetAttribute failed\n"); grid = -1; return; }
        int per_cu = 0;
        if (hipOccupancyMaxActiveBlocksPerMultiprocessor(&per_cu, (const void*)trunk_fwd, NWAVES * 64, LDS_BYTES) != hipSuccess || per_cu < 1) { fprintf(stderr, "kernel_launch: occupancy query says %d\n", per_cu); }
        (void)hipGetLastError();
        grid = cus > 0 ? cus : 256;
    }
    if (grid < 0) return;
    (void)hipMemsetAsync((char*)d_ws + WS_CTL, 0, CTL_ZERO_BYTES, stream);
    Args a{};
    for (int i = 0; i < 15; ++i) a.in[i] = (const float*)d_in[i];
    a.out = (float*)d_out; a.ws = (unsigned char*)d_ws; a.nlayers = NLAYERS; a.pad = 0;
#if MULTI_LAUNCH
    for (int ph = 0; ph < NPHASES; ++ph) { a.ph_lo = ph; a.ph_hi = ph + 1; hipLaunchKernelGGL(trunk_fwd, dim3(grid), dim3(NWAVES * 64), LDS_BYTES, stream, a); }
#else
    a.ph_lo = 0; a.ph_hi = NPHASES;
    hipLaunchKernelGGL(trunk_fwd, dim3(grid), dim3(NWAVES * 64), LDS_BYTES, stream, a);
#endif
}
```
